# Optimizing an MI355X kernel written in HIP

```python
import jax, jax.numpy as jnp
from jax import lax
import numpy as np

D_MODEL = 2048
BATCH = 4
SEQ = 2048
DEPTH = 1

CHUNK = 64
D_CONV = D_MODEL // 2
CONV_K = 3
D_POOL = D_MODEL // 2
POOL_WINDOWS = (2, 4, 8, 16)
N_POOL_GROUPS = len(POOL_WINDOWS)
POOL_GROUP_W = D_POOL // N_POOL_GROUPS
POOL_GROUP_OUT = D_MODEL // N_POOL_GROUPS
D_FF = ((8 * D_MODEL // 3 + 255) // 256) * 256
D_IN = 3 * D_CONV + D_POOL + 2 * D_MODEL
EPS = 1e-6

kernel_name = "hybrid_shortconv_multipool_gated_block"


def rmsnorm(x, g):
    xf = x.astype(jnp.float32)
    y = xf * lax.rsqrt(jnp.mean(xf * xf, axis=-1, keepdims=True) + EPS)
    return (y * g.astype(jnp.float32)).astype(x.dtype)


def causal_depthwise_conv(u, w, b):
    S = u.shape[1]
    up = jnp.pad(u, ((0, 0), (CONV_K - 1, 0), (0, 0)))
    out = b
    for k in range(CONV_K):
        out = out + w[k] * up[:, k:k + S]
    return out


def multiscale_pool(v):
    B, S, _ = v.shape
    vg = v.reshape(B, S, N_POOL_GROUPS, POOL_GROUP_W)
    vf = vg.astype(jnp.float32)
    cs = jnp.cumsum(vf, axis=1)
    cs = jnp.concatenate([jnp.zeros_like(cs[:, :1]), cs], axis=1)
    t = jnp.arange(S, dtype=jnp.int32)[:, None]
    win = jnp.asarray(POOL_WINDOWS, dtype=jnp.int32)[None, :]
    lo = jnp.maximum(t + 1 - win, 0)
    cnt = (t + 1 - lo).astype(jnp.float32)
    g_idx = jnp.arange(N_POOL_GROUPS, dtype=jnp.int32)[None, :]
    window_sum = cs[:, 1:] - cs[:, lo, g_idx, :]
    mean = window_sum / cnt[None, :, :, None]
    return (mean - vf).astype(v.dtype)


def swiglu(h, w_gate, w_up, w_down):
    return (jax.nn.silu(h @ w_gate) * (h @ w_up)) @ w_down


def setup_inputs(seed: int = 0) -> dict:
    key = jax.random.key(seed)
    ks = jax.random.split(key, 16)
    f32 = jnp.float32
    L = DEPTH
    nrm = lambda k, shape, fan_in: jax.random.normal(k, shape, f32) * (fan_in ** -0.5)
    return {
        "x": jax.random.normal(ks[0], (BATCH, SEQ, D_MODEL), f32),
        "norm1_g": 1.0 + 0.02 * jax.random.normal(ks[1], (L, D_MODEL), f32),
        "w_in": nrm(ks[2], (L, D_MODEL, D_IN), D_MODEL),
        "b_gate": 0.01 * jax.random.normal(ks[3], (L, 2 * D_MODEL), f32),
        "conv_w": nrm(ks[4], (L, CONV_K, D_CONV), CONV_K),
        "conv_b": 0.01 * jax.random.normal(ks[5], (L, D_CONV), f32),
        "w_a_out": nrm(ks[6], (L, D_CONV, D_MODEL), D_CONV),
        "w_pool": nrm(ks[7], (L, N_POOL_GROUPS, POOL_GROUP_W, POOL_GROUP_OUT), POOL_GROUP_W),
        "pool_scale": 1.0 + 0.02 * jax.random.normal(ks[8], (L, D_MODEL), f32),
        "w_o": nrm(ks[9], (L, D_MODEL, D_MODEL), D_MODEL),
        "norm2_g": 1.0 + 0.02 * jax.random.normal(ks[10], (L, D_MODEL), f32),
        "w_ffn_gate": nrm(ks[11], (L, D_MODEL, D_FF), D_MODEL),
        "w_ffn_up": nrm(ks[12], (L, D_MODEL, D_FF), D_MODEL),
        "w_ffn_down": nrm(ks[13], (L, D_FF, D_MODEL), D_FF),
        "final_g": 1.0 + 0.02 * jax.random.normal(ks[14], (D_MODEL,), f32),
    }


def reference(x, norm1_g, w_in, b_gate, conv_w, conv_b, w_a_out, w_pool, pool_scale,
              w_o, norm2_g, w_ffn_gate, w_ffn_up, w_ffn_down, final_g):
    B, S, _ = x.shape
    splits = np.cumsum([D_CONV, D_CONV, D_CONV, D_POOL, D_MODEL]).tolist()
    for l in range(DEPTH):
        h = rmsnorm(x, norm1_g[l])
        proj = h @ w_in[l]
        b_a, c_a, v_a, v_b, g_a, g_b = jnp.split(proj, splits, axis=-1)

        u = causal_depthwise_conv(c_a * v_a, conv_w[l], conv_b[l])
        y_a = (b_a * u) @ w_a_out[l]

        p = multiscale_pool(v_b)
        y_b = jnp.einsum("bsgc,gcd->bsgd", p, w_pool[l]).reshape(B, S, D_MODEL)
        y_b = y_b * pool_scale[l]

        gb = b_gate[l]
        merged = jax.nn.sigmoid(g_a + gb[:D_MODEL]) * y_a + jax.nn.sigmoid(g_b + gb[D_MODEL:]) * y_b
        x = x + merged @ w_o[l]

        h2 = rmsnorm(x, norm2_g[l])
        x = x + swiglu(h2, w_ffn_gate[l], w_ffn_up[l], w_ffn_down[l])
    return rmsnorm(x, final_g)
```

```cpp
#include <hip/hip_runtime.h>
#include <cstdio>
#include <cstdint>

#ifndef MK_N_LAUNCHES
#define MK_N_LAUNCHES 8
#endif

namespace pg8 {
#define PG8_LAS __attribute__((address_space(3)))
typedef unsigned short bf16_t;
typedef short bf16x8 __attribute__((ext_vector_type(8)));
typedef float f32x4 __attribute__((ext_vector_type(4)));
typedef unsigned u32x4 __attribute__((ext_vector_type(4)));
constexpr int BM = 256, BK = 64, HALF = 128, HTB = HALF * BK * 2  , STAGE_BYTES = 8 * HTB, NXCD = 8, WGM = 8;

__host__ __device__ __forceinline__ int lds_byte(int r, int c) { const int st = (r >> 4) * 2 + (c >> 5), rr = r & 15, cc = c & 31, ob = rr * 64 + cc * 2; return st * 1024 + (ob ^ (((ob >> 9) & 1) << 5)); }
__host__ __device__ __forceinline__ void stage_rc(int b, int& R, int& C) { const int st = b / 1024, sb = b % 1024, swz = sb ^ (((sb >> 9) & 1) << 5); R = (st >> 1) * 16 + swz / 64; C = (st & 1) * 32 + (swz % 64) / 2; }
__host__ __device__ __forceinline__ int perm32(int rho) { const int n = rho >> 4, i = rho & 15; return 8 * (i >> 2) + 4 * n + (i & 3); }

struct Unit { int pm, pn; };
struct Gemm { const bf16_t* A; const bf16_t* Bt; int lda, ldb, K, a_shift, a_stride; };

struct StaticOrder {
    int nM, nN, nwg, G, c;
    __host__ __device__ void init(int nM_, int nN_, int G_, int c_) { nM = nM_; nN = nN_; nwg = nM * nN; G = G_; c = c_; }
    __host__ __device__ bool next(int i, Unit& u) const {
        const long L = (long)i * G + c; if (L >= nwg) return false;
        int wgid = (int)L; { const int q = nwg / NXCD, r = nwg % NXCD, xcd = wgid % NXCD, off = wgid / NXCD; wgid = (xcd < r ? xcd * (q + 1) : r * (q + 1) + (xcd - r) * q) + off; }
        const int nig = WGM * nN, gid = wgid / nig, fm = gid * WGM, gsz = (nM - fm) < WGM ? (nM - fm) : WGM;
        u.pm = fm + ((wgid % nig) % gsz); u.pn = (wgid % nig) / gsz; return true;
    }
};

__device__ __forceinline__ unsigned cvt_pk_bf16(float lo, float hi) { unsigned r; asm volatile("v_cvt_pk_bf16_f32 %0, %1, %2" : "=v"(r) : "v"(lo), "v"(hi)); return r; }
__device__ __forceinline__ float bf_lo(unsigned w) { return __builtin_bit_cast(float, w << 16); }
__device__ __forceinline__ float bf_hi(unsigned w) { return __builtin_bit_cast(float, w & 0xffff0000u); }
__device__ __forceinline__ float sigmoidf_fast(float v) { return __builtin_amdgcn_rcpf(1.0f + __builtin_amdgcn_exp2f(v * -1.44269504089f)); }
__device__ __forceinline__ u32x4 pack8(const f32x4 v0, const f32x4 v1) { u32x4 w; w.x = cvt_pk_bf16(v0[0], v0[1]); w.y = cvt_pk_bf16(v0[2], v0[3]); w.z = cvt_pk_bf16(v1[0], v1[1]); w.w = cvt_pk_bf16(v1[2], v1[3]); return w; }
__device__ __forceinline__ void unpack8(const u32x4 w, f32x4& v0, f32x4& v1) { v0 = (f32x4){bf_lo(w.x), bf_hi(w.x), bf_lo(w.y), bf_hi(w.y)}; v1 = (f32x4){bf_lo(w.z), bf_hi(w.z), bf_lo(w.w), bf_hi(w.w)}; }


struct EpiProj {
    bf16_t* lo; bf16_t* hi; const float* bgate;
    __device__ __forceinline__ void operator()(const f32x4 (&acc)[2][2][4][2], const Unit& u, int wr, int wc, int fr, int fq) const {
        const int row0 = u.pm * BM + wr * 64 + fr; int colt = u.pn * BM; const bool ishi = colt >= 4096; bf16_t* base = ishi ? hi : lo; if (ishi) colt -= 4096;
        const int col0 = colt + wc * 32 + 8 * fq;
        f32x4 bv[2][2];
#pragma unroll
        for (int bj = 0; bj < 2; ++bj)
#pragma unroll
            for (int n = 0; n < 2; ++n) bv[bj][n] = ishi ? *(const f32x4*)(bgate + col0 + bj * HALF + 4 * n) : (f32x4){0.f, 0.f, 0.f, 0.f};
#pragma unroll
        for (int ai = 0; ai < 2; ++ai)
#pragma unroll
            for (int m = 0; m < 4; ++m) { bf16_t* rowp = base + (size_t)(row0 + ai * HALF + m * 16) * 4096 + col0;
#pragma unroll
                for (int bj = 0; bj < 2; ++bj) { f32x4 v0 = acc[ai][bj][m][0] + bv[bj][0], v1 = acc[ai][bj][m][1] + bv[bj][1];
                    if (ishi) {
#pragma unroll
                        for (int j = 0; j < 4; ++j) { v0[j] = sigmoidf_fast(v0[j]); v1[j] = sigmoidf_fast(v1[j]); } }
                    *(u32x4*)(rowp + bj * HALF) = pack8(v0, v1); } }
    }
};
struct EpiYb {
    const bf16_t* hi; bf16_t* ybs;
    __device__ __forceinline__ void operator()(const f32x4 (&acc)[2][2][4][2], const Unit& u, int wr, int wc, int fr, int fq) const {
        const int row0 = u.pm * BM + wr * 64 + fr, col0 = u.pn * BM + wc * 32 + 8 * fq;
#pragma unroll
        for (int ai = 0; ai < 2; ++ai)
#pragma unroll
            for (int m = 0; m < 4; ++m) { const size_t row = (size_t)(row0 + ai * HALF + m * 16);
#pragma unroll
                for (int bj = 0; bj < 2; ++bj) { const int c = col0 + bj * HALF; f32x4 s0, s1; unpack8(*(const u32x4*)(hi + row * 4096 + 2048 + c), s0, s1);
                    *(u32x4*)(ybs + row * 2048 + c) = pack8(acc[ai][bj][m][0] * s0, acc[ai][bj][m][1] * s1); } }
    }
};
struct EpiMerge {
    const bf16_t* hi; const bf16_t* ybs; bf16_t* out;
    __device__ __forceinline__ void operator()(const f32x4 (&acc)[2][2][4][2], const Unit& u, int wr, int wc, int fr, int fq) const {
        const int row0 = u.pm * BM + wr * 64 + fr, col0 = u.pn * BM + wc * 32 + 8 * fq;
#pragma unroll
        for (int ai = 0; ai < 2; ++ai)
#pragma unroll
            for (int m = 0; m < 4; ++m) { const size_t row = (size_t)(row0 + ai * HALF + m * 16);
#pragma unroll
                for (int bj = 0; bj < 2; ++bj) { const int c = col0 + bj * HALF; f32x4 s0, s1, y0, y1;
                    unpack8(*(const u32x4*)(hi + row * 4096 + c), s0, s1); unpack8(*(const u32x4*)(ybs + row * 2048 + c), y0, y1);
                    *(u32x4*)(out + row * 2048 + c) = pack8(acc[ai][bj][m][0] * s0 + y0, acc[ai][bj][m][1] * s1 + y1); } }
    }
};
struct EpiRes {
    const float* base; float* out; bf16_t* outb; float* part;
    __device__ __forceinline__ void operator()(const f32x4 (&acc)[2][2][4][2], const Unit& u, int wr, int wc, int fr, int fq) const {
        const int row0 = u.pm * BM + wr * 64 + fr, col0 = u.pn * BM + wc * 32 + 8 * fq;
#pragma unroll
        for (int ai = 0; ai < 2; ++ai)
#pragma unroll
            for (int m = 0; m < 4; ++m) { const size_t row = (size_t)(row0 + ai * HALF + m * 16); float ss = 0.f;
#pragma unroll
                for (int bj = 0; bj < 2; ++bj) { const size_t o = row * 2048 + col0 + bj * HALF;
                    const f32x4 v0 = acc[ai][bj][m][0] + *(const f32x4*)(base + o), v1 = acc[ai][bj][m][1] + *(const f32x4*)(base + o + 4);
                    *(f32x4*)(out + o) = v0; *(f32x4*)(out + o + 4) = v1;
                    if (outb) *(u32x4*)(outb + o) = pack8(v0, v1);
                    ss += (v0[0] * v0[0] + v0[1] * v0[1]) + (v0[2] * v0[2] + v0[3] * v0[3]) + (v1[0] * v1[0] + v1[1] * v1[1]) + (v1[2] * v1[2] + v1[3] * v1[3]); }
                ss += __shfl_xor(ss, 16); ss += __shfl_xor(ss, 32);
                if (fq == 0) part[row * 32 + u.pn * 4 + wc] = ss; }
    }
};
struct EpiSwiglu {
    const float* part; bf16_t* act; int ldact;
    __device__ __forceinline__ void operator()(const f32x4 (&acc)[2][2][4][2], const Unit& u, int wr, int wc, int fr, int fq) const {
        const int row0 = u.pm * BM + wr * 64 + fr, col0 = u.pn * HALF + wc * 32 + 8 * fq;
#pragma unroll
        for (int ai = 0; ai < 2; ++ai)
#pragma unroll
            for (int m = 0; m < 4; ++m) { const size_t row = (size_t)(row0 + ai * HALF + m * 16);
                const f32x4 p0 = *(const f32x4*)(part + row * 32 + 8 * fq), p1 = *(const f32x4*)(part + row * 32 + 8 * fq + 4);
                float s = ((p0[0] + p0[1]) + (p0[2] + p0[3])) + ((p1[0] + p1[1]) + (p1[2] + p1[3]));
                s += __shfl_xor(s, 16); s += __shfl_xor(s, 32);
                const float rs = __builtin_amdgcn_rsqf(s * (1.0f / 2048.0f) + 1e-6f);
                f32x4 o0, o1;
#pragma unroll
                for (int j = 0; j < 4; ++j) { const float g0 = acc[ai][0][m][0][j] * rs, u0 = acc[ai][1][m][0][j] * rs, g1 = acc[ai][0][m][1][j] * rs, u1 = acc[ai][1][m][1][j] * rs;
                    o0[j] = g0 * sigmoidf_fast(g0) * u0; o1[j] = g1 * sigmoidf_fast(g1) * u1; }
                *(u32x4*)(act + row * ldact + col0) = pack8(o0, o1); }
    }
};

template <class Epi, class Sched, bool ALIGN_EPI = false, bool SP2 = false>
__device__ __forceinline__ void gemm_phase(PG8_LAS unsigned char* lds, const Gemm g, const Sched& S, const Epi& E) {
    int tid = threadIdx.x; asm volatile("" : "+v"(tid));
    const int wid = __builtin_amdgcn_readfirstlane(tid >> 6), lane = tid & 63, wr = wid >> 2, wc = wid & 3, fr = lane & 15, fq = lane >> 4;
    const int K = g.K, nt = K / BK;
    unsigned voffA[2], voffB[2];
#pragma unroll
    for (int i = 0; i < 2; ++i) { int R, C; stage_rc(tid * 16 + i * 8192, R, C); const int Rb = (R & ~31) + perm32(R & 31);
        voffA[i] = (unsigned)(R * g.lda + C) * 2u; voffB[i] = (unsigned)(Rb * g.ldb + C) * 2u; }
    const size_t kstep = (size_t)(BK * 2);
    const size_t hstepA = (size_t)HALF * g.lda * 2, hstepB = (size_t)HALF * g.ldb * 2;
    const size_t tstepA = 2 * hstepA, tstepB = 2 * hstepB;
    const unsigned ldsw = (unsigned)wid * 1024u;
    const int aoff = lds_byte(wr * 64 + fr, fq * 8), boff = lds_byte(wc * 32 + fr, fq * 8);
#define PG8_SA(b, h) (((b) * 2 + (h)) * HTB)
#define PG8_SB(b, h) ((4 + (b) * 2 + (h)) * HTB)
#define PG8_STAGE(bufoff, gbase, voff) do { _Pragma("unroll") for (int _i = 0; _i < 2; ++_i) \
        __builtin_amdgcn_global_load_lds((const unsigned*)((const char*)(gbase) + (voff)[_i]), (PG8_LAS unsigned*)(lds + (bufoff) + ldsw + _i * 8192), 16, 0, 0); } while (0)
#define PG8_LDA(dst, b, h) do { _Pragma("unroll") for (int m = 0; m < 4; ++m) _Pragma("unroll") for (int k = 0; k < 2; ++k) dst[m][k] = *(const PG8_LAS bf16x8*)(lds + PG8_SA(b, h) + aoff + m * 2048 + k * 1024); } while (0)
#define PG8_LDB(dst, b, h) do { _Pragma("unroll") for (int n = 0; n < 2; ++n) _Pragma("unroll") for (int k = 0; k < 2; ++k) dst[n][k] = *(const PG8_LAS bf16x8*)(lds + PG8_SB(b, h) + boff + n * 2048 + k * 1024); } while (0)
#define PG8_MMA(ai, bj, At, Bt) do { __builtin_amdgcn_s_setprio(1); _Pragma("unroll") for (int m = 0; m < 4; ++m) _Pragma("unroll") for (int n = 0; n < 2; ++n) _Pragma("unroll") for (int k = 0; k < 2; ++k) \
        acc[ai][bj][m][n] = __builtin_amdgcn_mfma_f32_16x16x32_bf16(Bt[n][k], At[m][k], acc[ai][bj][m][n], 0, 0, 0); __builtin_amdgcn_s_setprio(0); } while (0)
#define PG8_WAIT_V(n) asm volatile("s_waitcnt vmcnt(" #n ")" ::: "memory")
#define PG8_WAIT_L(n) asm volatile("s_waitcnt lgkmcnt(" #n ")" ::: "memory")
#define PG8_BAR __builtin_amdgcn_s_barrier()
#define PG8_SCHED __builtin_amdgcn_sched_barrier(0)
#define PG8_UA(u) ((const char*)g.A + (size_t)(u).pm * tstepA + (size_t)(((u).pn >> g.a_shift) * g.a_stride) * 2)
#define PG8_UB(u) ((const char*)g.Bt + (size_t)(u).pn * tstepB)
    Unit cur, nxt; int ui = 0;
    if (!S.next(0, cur)) return;
    f32x4 acc[2][2][4][2];
#pragma unroll
    for (int a = 0; a < 2; ++a)
#pragma unroll
        for (int b = 0; b < 2; ++b)
#pragma unroll
            for (int m = 0; m < 4; ++m)
#pragma unroll
                for (int n = 0; n < 2; ++n) acc[a][b][m][n] = (f32x4){0.f, 0.f, 0.f, 0.f};
    bf16x8 At[4][2], B0[2][2], B1[2][2];
    const char* cA = PG8_UA(cur); const char* cB = PG8_UB(cur);
    if constexpr (SP2) {
        PG8_STAGE(PG8_SB(0, 0), cB, voffB); PG8_STAGE(PG8_SB(0, 1), cB + hstepB, voffB); PG8_STAGE(PG8_SA(0, 0), cA, voffA); PG8_STAGE(PG8_SA(0, 1), cA + hstepA, voffA);
        if (wr == 1) PG8_BAR;
        PG8_WAIT_V(2); PG8_BAR;
        PG8_STAGE(PG8_SB(1, 0), cB + kstep, voffB); PG8_STAGE(PG8_SA(1, 0), cA + kstep, voffA); PG8_STAGE(PG8_SB(1, 1), cB + hstepB + kstep, voffB);
        PG8_WAIT_V(6); PG8_BAR;
    } else {
        PG8_STAGE(PG8_SB(0, 0), cB, voffB); PG8_STAGE(PG8_SA(0, 0), cA, voffA); PG8_STAGE(PG8_SB(0, 1), cB + hstepB, voffB); PG8_STAGE(PG8_SA(0, 1), cA + hstepA, voffA);
        if (wr == 1) PG8_BAR;
        PG8_WAIT_V(4); PG8_BAR;
        PG8_STAGE(PG8_SB(1, 0), cB + kstep, voffB); PG8_STAGE(PG8_SA(1, 0), cA + kstep, voffA); PG8_STAGE(PG8_SB(1, 1), cB + hstepB + kstep, voffB);
        PG8_WAIT_V(6); PG8_BAR;
    }
    for (;;) {
        const bool has_next = S.next(ui + 1, nxt);
        const char* nA = has_next ? PG8_UA(nxt) : cA; const char* nB = has_next ? PG8_UB(nxt) : cB;
        for (int t = 0; t < nt; t += 2) {
            const bool last = (t == nt - 2);
            const char* a1 = cA + (size_t)(t + 1) * kstep;
            const char* a2 = last ? nA : cA + (size_t)(t + 2) * kstep; const char* b2 = last ? nB : cB + (size_t)(t + 2) * kstep;
            const char* a3 = a2 + kstep; const char* b3 = b2 + kstep;
            if constexpr (SP2) {
            PG8_LDB(B0, 0, 0); PG8_LDB(B1, 0, 1); PG8_SCHED; PG8_LDA(At, 0, 0); PG8_STAGE(PG8_SA(1, 1), a1 + hstepA, voffA);
            PG8_WAIT_V(8); PG8_WAIT_L(0); PG8_BAR; PG8_MMA(0, 0, At, B0); PG8_MMA(0, 1, At, B1); PG8_BAR; PG8_SCHED;
            PG8_LDA(At, 0, 1); PG8_STAGE(PG8_SB(0, 0), b2, voffB); PG8_STAGE(PG8_SB(0, 1), b2 + hstepB, voffB); PG8_STAGE(PG8_SA(0, 0), a2, voffA);
            PG8_WAIT_V(8); PG8_WAIT_L(0); PG8_BAR; PG8_MMA(1, 0, At, B0); PG8_MMA(1, 1, At, B1); PG8_BAR; PG8_SCHED;
            PG8_LDB(B0, 1, 0); PG8_LDB(B1, 1, 1); PG8_SCHED; PG8_LDA(At, 1, 0); PG8_STAGE(PG8_SA(0, 1), a2 + hstepA, voffA);
            PG8_WAIT_V(8); PG8_WAIT_L(0); PG8_BAR; PG8_MMA(0, 0, At, B0); PG8_MMA(0, 1, At, B1); PG8_BAR; PG8_SCHED;
            PG8_LDA(At, 1, 1); PG8_STAGE(PG8_SB(1, 0), b3, voffB); PG8_STAGE(PG8_SB(1, 1), b3 + hstepB, voffB); PG8_STAGE(PG8_SA(1, 0), a3, voffA);
            PG8_WAIT_V(8); PG8_WAIT_L(0); PG8_BAR; PG8_MMA(1, 0, At, B0); PG8_MMA(1, 1, At, B1); PG8_BAR; PG8_SCHED;
            } else {
            PG8_LDB(B0, 0, 0); PG8_SCHED; PG8_LDA(At, 0, 0); PG8_STAGE(PG8_SA(1, 1), a1 + hstepA, voffA);
            PG8_WAIT_L(8); PG8_BAR; PG8_WAIT_L(0); PG8_MMA(0, 0, At, B0); PG8_BAR; PG8_SCHED;
            PG8_LDB(B1, 0, 1); PG8_STAGE(PG8_SB(0, 0), b2, voffB);
            PG8_BAR; PG8_WAIT_L(0); PG8_MMA(0, 1, At, B1); PG8_BAR;
            PG8_LDA(At, 0, 1); PG8_STAGE(PG8_SA(0, 0), a2, voffA);
            PG8_BAR; PG8_WAIT_L(0); PG8_MMA(1, 0, At, B0); PG8_BAR; PG8_SCHED;
            PG8_STAGE(PG8_SB(0, 1), b2 + hstepB, voffB);
            PG8_WAIT_V(6); PG8_BAR; PG8_MMA(1, 1, At, B1); PG8_BAR;
            PG8_LDB(B0, 1, 0); PG8_SCHED; PG8_LDA(At, 1, 0); PG8_STAGE(PG8_SA(0, 1), a2 + hstepA, voffA);
            PG8_WAIT_L(8); PG8_BAR; PG8_WAIT_L(0); PG8_MMA(0, 0, At, B0); PG8_BAR; PG8_SCHED;
            PG8_LDB(B1, 1, 1); PG8_STAGE(PG8_SB(1, 0), b3, voffB);
            PG8_BAR; PG8_WAIT_L(0); PG8_MMA(0, 1, At, B1); PG8_BAR;
            PG8_LDA(At, 1, 1); PG8_STAGE(PG8_SA(1, 0), a3, voffA);
            PG8_BAR; PG8_WAIT_L(0); PG8_MMA(1, 0, At, B0); PG8_BAR; PG8_SCHED;
            PG8_STAGE(PG8_SB(1, 1), b3 + hstepB, voffB);
            PG8_WAIT_V(6); PG8_BAR; PG8_MMA(1, 1, At, B1); PG8_BAR;
            }
        }
        if constexpr (ALIGN_EPI) { if (wr == 0) PG8_BAR; }
        E(acc, cur, wr, wc, fr, fq);
        if (!has_next) break;
#pragma unroll
        for (int a = 0; a < 2; ++a)
#pragma unroll
            for (int b = 0; b < 2; ++b)
#pragma unroll
                for (int m = 0; m < 4; ++m)
#pragma unroll
                    for (int n = 0; n < 2; ++n) acc[a][b][m][n] = (f32x4){0.f, 0.f, 0.f, 0.f};
        cur = nxt; cA = nA; cB = nB; ++ui;
        if constexpr (ALIGN_EPI) { if (wr == 1) PG8_BAR; }
    }
    PG8_WAIT_V(0);
    if constexpr (!ALIGN_EPI) { if (wr == 0) PG8_BAR; }
    PG8_BAR;
#undef PG8_SA
#undef PG8_SB
#undef PG8_STAGE
#undef PG8_LDA
#undef PG8_LDB
#undef PG8_MMA
#undef PG8_WAIT_V
#undef PG8_WAIT_L
#undef PG8_BAR
#undef PG8_SCHED
#undef PG8_UA
#undef PG8_UB
}
}

constexpr int NWAVES = 8;
constexpr int N_LAUNCHES = MK_N_LAUNCHES;
constexpr int PER_PHASE = 8;

constexpr int SEQ = 2048, M = 4 * SEQ, D = 2048, DIN = 8192, DC = 1024, DPL = 1024, FF = 5632;
constexpr float EPS = 1e-6f;

constexpr size_t MiB = 1u << 20;
constexpr size_t WS_CTL = 0, CTL_ZERO_BYTES = 64 * 1024;
constexpr size_t WS_PART2 = 2 * MiB, WS_PART3 = 3 * MiB;
constexpr size_t WS_WA = 4 * MiB;
constexpr size_t WS_WP = 8 * MiB;
constexpr size_t WS_WO = 9 * MiB;
constexpr size_t WS_WGU = 17 * MiB;
constexpr size_t WS_WD = 61 * MiB;
constexpr size_t WS_WIN = 83 * MiB;
constexpr size_t WS_PLO = 115 * MiB;
constexpr size_t WS_PHI = 179 * MiB;
constexpr size_t WS_XB = 243 * MiB;
constexpr size_t WS_END = 275 * MiB;
static_assert(WS_WIN + (size_t)M * FF * 2 <= WS_PHI, "ACT overlay stays below PHI");
constexpr int CW_BAR = 4096;

constexpr int RING_OFF = 0, RING_BYTES = 131072;
constexpr int LDSCTL_OFF = RING_BYTES, MISC_OFF = LDSCTL_OFF + 320;
constexpr int LDS_BYTES = 147456;
static_assert(MISC_OFF + 128 <= LDS_BYTES, "LDS map");

#define GAS __attribute__((address_space(1)))
#define LAS __attribute__((address_space(3)))
typedef unsigned short bf16;
typedef unsigned v4u __attribute__((ext_vector_type(4)));
typedef float f32x4 __attribute__((ext_vector_type(4)));
#define LDS_WAIT() asm volatile("s_waitcnt lgkmcnt(0)" ::: "memory")
__device__ __forceinline__ unsigned f2bf(float f) { unsigned u = __builtin_bit_cast(unsigned, f); return (u + 0x7fffu + ((u >> 16) & 1u)) >> 16; }
__device__ __forceinline__ unsigned pk2(float lo, float hi) { return f2bf(lo) | (f2bf(hi) << 16); }

#define XB_TMO      128
#define XB_XCNT(j)  (256  + 64 * (j))
#define XB_XSUB(j)  (1280 + 64 * (j))
#define XB_XGEN(j)  (2304 + 64 * (j))
#define XB_TOP      3328
#define XB_TOPGEN   3392
#define XCD_BAR_WORDS 3456
#define XB_SPIN_CAP (1u << 18)
static_assert((CW_BAR + XCD_BAR_WORDS) * 4 <= (int)CTL_ZERO_BYTES, "barrier words inside the memset region");

__device__ __forceinline__ unsigned xb_ld(unsigned* p)              { return __hip_atomic_load(p, __ATOMIC_RELAXED, __HIP_MEMORY_SCOPE_AGENT); }
__device__ __forceinline__ unsigned xb_add(unsigned* p, unsigned v) { return __hip_atomic_fetch_add(p, v, __ATOMIC_RELAXED, __HIP_MEMORY_SCOPE_AGENT); }
__device__ __forceinline__ unsigned xb_xcc_id() { return (unsigned)__builtin_amdgcn_s_getreg((3 << 11) | 20) & 0xFu; }
#define XB_SPIN(cond, bar) do { unsigned _sp = 0; while (cond) { __builtin_amdgcn_s_sleep(1); \
    if ((++_sp & 255u) == 0u) { if (xb_ld(&(bar)[XB_TMO])) break; if (_sp > XB_SPIN_CAP) { atomicAdd(&(bar)[XB_TMO], 1u); break; } } } } while (0)

struct XcdBarrier {
    unsigned* bar; unsigned x;
    volatile LAS unsigned* st;
};
__device__ __forceinline__ XcdBarrier xcd_barrier_post(unsigned* bar, volatile LAS unsigned* st) {
    XcdBarrier b; b.bar = bar; b.x = xb_xcc_id(); b.st = st;
    if (threadIdx.x == 0) (void)xb_add(&bar[XB_XCNT(b.x)], 1u);
    return b;
}
__device__ __forceinline__ void xcd_barrier_complete(unsigned* bar, unsigned x, unsigned& nloc, unsigned& nx) {
    const unsigned G = gridDim.x * gridDim.y * gridDim.z;
    unsigned sum, cnt, mine, sp = 0u;
    for (;;) {
        sum = 0u; cnt = 0u; mine = 0u;
#pragma unroll
        for (unsigned j = 0; j < 16; ++j) { const unsigned c = xb_ld(&bar[XB_XCNT(j)]); sum += c; cnt += (c > 0u) ? 1u : 0u; mine = (j == x) ? c : mine; }
        if (sum == G) break;
        __builtin_amdgcn_s_sleep(1);
        if ((++sp & 255u) == 0u) { if (xb_ld(&bar[XB_TMO])) break; if (sp > XB_SPIN_CAP) { atomicAdd(&bar[XB_TMO], 1u); break; } }
    }
    nloc = mine > 0u ? mine : 1u; nx = cnt > 0u ? cnt : 1u;
}
__device__ __forceinline__ void xcd_barrier(const XcdBarrier& b) {
    asm volatile("s_waitcnt vmcnt(0)" ::: "memory");
    __syncthreads();
    if (threadIdx.x == 0) {
        unsigned* bar = b.bar;
        __builtin_amdgcn_s_waitcnt(0);
        unsigned nloc = b.st[0], nx = b.st[1];
        if (nloc == 0u) { xcd_barrier_complete(bar, b.x, nloc, nx); b.st[0] = nloc; b.st[1] = nx; }
        const unsigned old = xb_add(&bar[XB_XSUB(b.x)], 1u);
        const unsigned gen = old / nloc;
        if (old + 1u == (gen + 1u) * nloc) {
            __builtin_amdgcn_fence(__ATOMIC_RELEASE, "agent");
            asm volatile("s_waitcnt vmcnt(0)" ::: "memory");
            const unsigned og = xb_add(&bar[XB_TOP], 1u);
            const unsigned tg = og / nx;
            if (og + 1u == (tg + 1u) * nx) xb_add(&bar[XB_TOPGEN], 1u);
            else XB_SPIN(xb_ld(&bar[XB_TOPGEN]) == tg, bar);
            __builtin_amdgcn_fence(__ATOMIC_ACQUIRE, "agent");
            xb_add(&bar[XB_XGEN(b.x)], 1u);
            asm volatile("s_waitcnt vmcnt(0)" ::: "memory");
        } else {
            XB_SPIN(xb_ld(&bar[XB_XGEN(b.x)]) == gen, bar);
            __builtin_amdgcn_fence(__ATOMIC_ACQUIRE, "agent");
            asm volatile("s_waitcnt vmcnt(0)" ::: "memory");
        }
    }
    __syncthreads();
}

__device__ __forceinline__ float wave_sum(float v) {
#pragma unroll
    for (int o = 1; o < 64; o <<= 1) v += __shfl_xor(v, o);
    return v;
}
__device__ __forceinline__ void p0_transpose_item(const float* W, int K, int N, bf16* WT, const float* ks, const float* ns, int blk, int blk_stride, int row_off, LAS float* scr, int item, int lane) {
    const int nblk = N / 32, kb = item / nblk, nb = item % nblk, k0 = 64 * kb, n0 = 32 * nb;
#pragma unroll 8
    for (int i = 0; i < 32; ++i) { const int kk = 2 * i + (lane >> 5); float w = W[(size_t)(k0 + kk) * N + n0 + (lane & 31)]; if (ks) w *= ks[k0 + kk]; scr[kk * 33 + (lane & 31)] = w; }
    LDS_WAIT(); asm volatile("" ::: "memory");
    const int c = lane & 7;
#pragma unroll
    for (int j = 0; j < 4; ++j) { const int n = (lane >> 3) + 8 * j; const LAS float* s = scr + (8 * c) * 33 + n; const int ng = n0 + n;
        const float sc = ns ? ns[ng] : 1.0f;
        v4u o; o.x = pk2(s[0 * 33] * sc, s[1 * 33] * sc); o.y = pk2(s[2 * 33] * sc, s[3 * 33] * sc); o.z = pk2(s[4 * 33] * sc, s[5 * 33] * sc); o.w = pk2(s[6 * 33] * sc, s[7 * 33] * sc);
        const int drow = row_off + (ng / blk) * blk_stride + (ng % blk);
        *(v4u*)(WT + (size_t)drow * K + k0 + 8 * c) = o; }
    LDS_WAIT(); asm volatile("" ::: "memory");
}

struct Args { const float* in[15]; float* out; unsigned char* ws; int ph_lo, ph_hi, li, pad; };

__global__ void __launch_bounds__(NWAVES * 64, 2) fwd_megakernel(Args args) {
    extern __shared__ __attribute__((aligned(16))) unsigned char lds_raw[];
    LAS unsigned char* lds = (LAS unsigned char*)lds_raw;
    volatile LAS unsigned* MISC = (volatile LAS unsigned*)(lds + MISC_OFF);
    const int tid = threadIdx.x, lane = tid & 63, wave = __builtin_amdgcn_readfirstlane(tid >> 6);
    const int G = gridDim.x; const int bx = blockIdx.x; const int vcu = (G % 8 == 0) ? (bx % 8) * (G / 8) + bx / 8 : bx;
    unsigned char* ws = args.ws;
    const float* x = args.in[0]; const float* norm1_g = args.in[1]; const float* w_in = args.in[2]; const float* b_gate = args.in[3];
    const float* conv_w = args.in[4]; const float* conv_b = args.in[5]; const float* w_a_out = args.in[6]; const float* w_pool = args.in[7];
    const float* pool_scale = args.in[8]; const float* w_o = args.in[9]; const float* norm2_g = args.in[10]; const float* w_gate = args.in[11];
    const float* w_up = args.in[12]; const float* w_down = args.in[13]; const float* final_g = args.in[14];
    float* out = args.out;
    bf16* WA = (bf16*)(ws + WS_WA); bf16* WP = (bf16*)(ws + WS_WP); bf16* WO = (bf16*)(ws + WS_WO); bf16* WGU = (bf16*)(ws + WS_WGU); bf16* WD = (bf16*)(ws + WS_WD);
    bf16* WIN = (bf16*)(ws + WS_WIN); bf16* ZP = (bf16*)(ws + WS_WIN); bf16* ACT = (bf16*)(ws + WS_WIN);
    bf16* PLO = (bf16*)(ws + WS_PLO); bf16* MERGED = (bf16*)(ws + WS_PLO); bf16* PHI = (bf16*)(ws + WS_PHI);
    bf16* XB = (bf16*)(ws + WS_XB); bf16* YBS = (bf16*)(ws + WS_XB); bf16* X1B = (bf16*)(ws + WS_XB);
    float* PART2 = (float*)(ws + WS_PART2); float* PART3 = (float*)(ws + WS_PART3);

    for (int u = tid; u < (LDS_BYTES - LDSCTL_OFF) / 4; u += NWAVES * 64) ((LAS unsigned*)(lds + LDSCTL_OFF))[u] = 0u;
    __syncthreads();
    XcdBarrier bar; bar.bar = (unsigned*)(ws + WS_CTL) + CW_BAR; bar.x = 0; bar.st = nullptr;
    if (N_LAUNCHES != PER_PHASE) bar = xcd_barrier_post((unsigned*)(ws + WS_CTL) + CW_BAR, MISC + 8);
#define GRID_BAR() do { if (N_LAUNCHES != PER_PHASE) xcd_barrier(bar); } while (0)
    const int lo = args.ph_lo, hi = args.ph_hi;
#define IN(k) (lo <= (k) && (k) < hi)
#define BOTH(k) (IN(k) && IN((k) + 1))
    const int gw = vcu * NWAVES + wave, NGW = G * NWAVES;

    if (IN(0)) {
        LAS float* scr = (LAS float*)(lds + RING_OFF + wave * 16384);
        constexpr int I_IN = (D / 64) * (DIN / 32), I_A = (DC / 64) * (D / 32), I_P = (256 / 64) * (512 / 32), I_O = (D / 64) * (D / 32), I_G = (D / 64) * (FF / 32), I_D = (FF / 64) * (D / 32);
        constexpr int NITEMS = I_IN + I_A + 4 * I_P + I_O + 2 * I_G + I_D;
        for (int it = gw; it < NITEMS; it += NGW) {
            int r = it;
            if (r < I_IN) { p0_transpose_item(w_in, D, DIN, WIN, norm1_g, nullptr, DIN, DIN, 0, scr, r, lane); continue; } r -= I_IN;
            if (r < I_A) { p0_transpose_item(w_a_out, DC, D, WA, nullptr, nullptr, D, D, 0, scr, r, lane); continue; } r -= I_A;
            if (r < 4 * I_P) { const int g = r / I_P; p0_transpose_item(w_pool + (size_t)g * 256 * 512, 256, 512, WP, nullptr, pool_scale + g * 512, 512, 512, g * 512, scr, r % I_P, lane); continue; } r -= 4 * I_P;
            if (r < I_O) { p0_transpose_item(w_o, D, D, WO, nullptr, nullptr, D, D, 0, scr, r, lane); continue; } r -= I_O;
            if (r < I_G) { p0_transpose_item(w_gate, D, FF, WGU, norm2_g, nullptr, 128, 256, 0, scr, r, lane); continue; } r -= I_G;
            if (r < I_G) { p0_transpose_item(w_up, D, FF, WGU, norm2_g, nullptr, 128, 256, 128, scr, r, lane); continue; } r -= I_G;
            p0_transpose_item(w_down, FF, D, WD, nullptr, nullptr, D, D, 0, scr, r, lane);
        }
        for (int m = gw; m < M; m += NGW) {
            const f32x4* xr = (const f32x4*)(x + (size_t)m * D) + lane;
            f32x4 v[8]; float s = 0.f;
#pragma unroll
            for (int j = 0; j < 8; ++j) { v[j] = xr[64 * j]; s += (v[j][0] * v[j][0] + v[j][1] * v[j][1]) + (v[j][2] * v[j][2] + v[j][3] * v[j][3]); }
            const float rs = 1.0f / sqrtf(wave_sum(s) * (1.0f / D) + EPS);
            unsigned long long* o8 = (unsigned long long*)(XB + (size_t)m * D) + lane;
#pragma unroll
            for (int j = 0; j < 8; ++j) o8[64 * j] = (unsigned long long)pk2(v[j][0] * rs, v[j][1] * rs) | ((unsigned long long)pk2(v[j][2] * rs, v[j][3] * rs) << 32);
        }
        if (BOTH(0)) GRID_BAR();
    }

    if (IN(1)) {
        pg8::Gemm g{XB, WIN, D, D, D, 0, 0}; pg8::StaticOrder S; S.init(M / 256, DIN / 256, G, bx);
        pg8::EpiProj E{PLO, PHI, b_gate};
        pg8::gemm_phase<pg8::EpiProj, pg8::StaticOrder, true, true>(lds + RING_OFF, g, S, E);
        if (BOTH(1)) GRID_BAR();
    }

    if (IN(2)) {
        const int chunk = tid & 255, sub = tid >> 8;
        for (int rb = vcu; rb < M / 32; rb += G) {
            const int m0 = rb * 32 + sub * 16, t0 = m0 & (SEQ - 1);
            if (chunk < 128) {
                const int c0 = chunk * 8;
                float w0[8], w1[8], w2[8], cb[8], cv1[8], cv2[8];
#pragma unroll
                for (int e = 0; e < 8; ++e) { w0[e] = conv_w[c0 + e]; w1[e] = conv_w[DC + c0 + e]; w2[e] = conv_w[2 * DC + c0 + e]; cb[e] = conv_b[c0 + e]; cv1[e] = 0.f; cv2[e] = 0.f; }
                if (t0 > 0) {
                    pg8::f32x4 a0, a1, b0, b1;
                    pg8::unpack8(*(const v4u*)(PLO + (size_t)(m0 - 1) * 4096 + 1024 + c0), a0, a1); pg8::unpack8(*(const v4u*)(PLO + (size_t)(m0 - 1) * 4096 + 2048 + c0), b0, b1);
#pragma unroll
                    for (int e = 0; e < 4; ++e) { cv1[e] = a0[e] * b0[e]; cv1[4 + e] = a1[e] * b1[e]; }
                    pg8::unpack8(*(const v4u*)(PLO + (size_t)(m0 - 2) * 4096 + 1024 + c0), a0, a1); pg8::unpack8(*(const v4u*)(PLO + (size_t)(m0 - 2) * 4096 + 2048 + c0), b0, b1);
#pragma unroll
                    for (int e = 0; e < 4; ++e) { cv2[e] = a0[e] * b0[e]; cv2[4 + e] = a1[e] * b1[e]; }
                }
#pragma unroll 4
                for (int i = 0; i < 16; ++i) { const size_t m = (size_t)(m0 + i);
                    pg8::f32x4 ba0, ba1, ca0, ca1, va0, va1;
                    pg8::unpack8(*(const v4u*)(PLO + m * 4096 + c0), ba0, ba1); pg8::unpack8(*(const v4u*)(PLO + m * 4096 + 1024 + c0), ca0, ca1); pg8::unpack8(*(const v4u*)(PLO + m * 4096 + 2048 + c0), va0, va1);
                    float cv[8], z[8];
#pragma unroll
                    for (int e = 0; e < 4; ++e) { cv[e] = ca0[e] * va0[e]; cv[4 + e] = ca1[e] * va1[e]; }
#pragma unroll
                    for (int e = 0; e < 8; ++e) { const float uu = cb[e] + w0[e] * cv2[e] + w1[e] * cv1[e] + w2[e] * cv[e]; z[e] = (e < 4 ? ba0[e] : ba1[e - 4]) * uu; cv2[e] = cv1[e]; cv1[e] = cv[e]; }
                    v4u o; o.x = pk2(z[0], z[1]); o.y = pk2(z[2], z[3]); o.z = pk2(z[4], z[5]); o.w = pk2(z[6], z[7]);
                    *(v4u*)(ZP + m * 2048 + c0) = o; }
            } else {
                const int c0 = (chunk - 128) * 8, w = 2 << (c0 >> 8);
                const bf16* vb = PLO + 3072 + c0;
                float s[8];
#pragma unroll
                for (int e = 0; e < 8; ++e) s[e] = 0.f;
                if (t0 > 0) for (int i = 1; i < w; ++i) { pg8::f32x4 a0, a1; pg8::unpack8(*(const v4u*)(vb + (size_t)(m0 - i) * 4096), a0, a1);
#pragma unroll
                    for (int e = 0; e < 4; ++e) { s[e] += a0[e]; s[4 + e] += a1[e]; } }
                for (int i = 0; i < 16; ++i) { const size_t m = (size_t)(m0 + i); const int t = t0 + i;
                    pg8::f32x4 a0, a1; pg8::unpack8(*(const v4u*)(vb + m * 4096), a0, a1);
                    const float inv = 1.0f / (float)(t + 1 < w ? t + 1 : w);
                    float p[8];
#pragma unroll
                    for (int e = 0; e < 4; ++e) { s[e] += a0[e]; s[4 + e] += a1[e]; p[e] = s[e] * inv - a0[e]; p[4 + e] = s[4 + e] * inv - a1[e]; }
                    v4u o; o.x = pk2(p[0], p[1]); o.y = pk2(p[2], p[3]); o.z = pk2(p[4], p[5]); o.w = pk2(p[6], p[7]);
                    *(v4u*)(ZP + m * 2048 + 1024 + c0) = o;
                    if (t - w + 1 >= 0) { pg8::f32x4 r0, r1; pg8::unpack8(*(const v4u*)(vb + (m - w + 1) * 4096), r0, r1);
#pragma unroll
                        for (int e = 0; e < 4; ++e) { s[e] -= r0[e]; s[4 + e] -= r1[e]; } } }
            }
        }
        if (BOTH(2)) GRID_BAR();
    }

    if (IN(3)) {
        { pg8::Gemm g{ZP + 1024, WP, 2048, 256, 256, 1, 256}; pg8::StaticOrder S; S.init(M / 256, D / 256, G, bx);
          pg8::EpiYb E{PHI, YBS};
          pg8::gemm_phase<pg8::EpiYb, pg8::StaticOrder, true, true>(lds + RING_OFF, g, S, E); }
        { pg8::Gemm g{ZP, WA, 2048, DC, DC, 0, 0}; pg8::StaticOrder S; S.init(M / 256, D / 256, G, bx);
          pg8::EpiMerge E{PHI, YBS, MERGED};
          pg8::gemm_phase<pg8::EpiMerge, pg8::StaticOrder, true, true>(lds + RING_OFF, g, S, E); }
        if (BOTH(3)) GRID_BAR();
    }

    if (IN(4)) {
        pg8::Gemm g{MERGED, WO, D, D, D, 0, 0}; pg8::StaticOrder S; S.init(M / 256, D / 256, G, bx);
        pg8::EpiRes E{x, out, X1B, PART2};
        pg8::gemm_phase<pg8::EpiRes, pg8::StaticOrder, true, true>(lds + RING_OFF, g, S, E);
        if (BOTH(4)) GRID_BAR();
    }

    if (IN(5)) {
        pg8::Gemm g{X1B, WGU, D, D, D, 0, 0}; pg8::StaticOrder S; S.init(M / 256, 2 * FF / 256, G, bx);
        pg8::EpiSwiglu E{PART2, ACT, FF};
        pg8::gemm_phase<pg8::EpiSwiglu, pg8::StaticOrder, true, true>(lds + RING_OFF, g, S, E);
        if (BOTH(5)) GRID_BAR();
    }

    if (IN(6)) {
        pg8::Gemm g{ACT, WD, FF, FF, FF, 0, 0}; pg8::StaticOrder S; S.init(M / 256, D / 256, G, bx);
        pg8::EpiRes E{out, out, nullptr, PART3};
        pg8::gemm_phase<pg8::EpiRes, pg8::StaticOrder, true, true>(lds + RING_OFF, g, S, E);
        if (BOTH(6)) GRID_BAR();
    }

    if (IN(7)) {
        for (int m = gw; m < M; m += NGW) {
            float s = (lane < 32) ? PART3[(size_t)m * 32 + lane] : 0.f;
            const float rs = 1.0f / sqrtf(wave_sum(s) * (1.0f / D) + EPS);
            f32x4* xr = (f32x4*)(out + (size_t)m * D) + lane; const f32x4* gr = (const f32x4*)final_g + lane;
#pragma unroll
            for (int j = 0; j < 8; ++j) { const f32x4 v = xr[64 * j], gg = gr[64 * j]; xr[64 * j] = v * rs * gg; }
        }
    }
#undef IN
#undef BOTH
#undef GRID_BAR
}

extern "C" void kernel_launch(void* const* d_in, const int* in_sizes, int n_in, void* d_out, int out_size, void* d_ws, size_t ws_size, hipStream_t stream) {
    static int grid = 0;
    if (grid == 0) {
        if (n_in != 15 || in_sizes[0] != M * D || out_size != M * D || ws_size < WS_END) { fprintf(stderr, "kernel_launch: built for 15 inputs, x and out of %d floats, >= %zu bytes of workspace; got n_in %d, in0 %d, out %d, ws %zu; nothing launched\n", M * D, (size_t)WS_END, n_in, n_in > 0 ? in_sizes[0] : -1, out_size, ws_size); grid = -1; return; }
        int dev = 0, cus = 0, per_cu = 0;
        if (hipGetDevice(&dev) != hipSuccess || hipDeviceGetAttribute(&cus, hipDeviceAttributeMultiprocessorCount, dev) != hipSuccess) { fprintf(stderr, "kernel_launch: hipGetDevice / hipDeviceGetAttribute failed; nothing launched\n"); grid = -1; return; }
        if (hipFuncSetAttribute((const void*)fwd_megakernel, hipFuncAttributeMaxDynamicSharedMemorySize, LDS_BYTES) != hipSuccess) { fprintf(stderr, "kernel_launch: hipFuncSetAttribute failed; nothing launched\n"); grid = -1; return; }
        if (hipOccupancyMaxActiveBlocksPerMultiprocessor(&per_cu, (const void*)fwd_megakernel, NWAVES * 64, LDS_BYTES) != hipSuccess || per_cu < 1)
            fprintf(stderr, "kernel_launch: note: the occupancy query reports %d workgroups per CU\n", per_cu);
        (void)hipGetLastError();
        grid = cus;
    }
    if (grid < 0) return;
    if (hipMemsetAsync((char*)d_ws + WS_CTL, 0, CTL_ZERO_BYTES, stream) != hipSuccess) { fprintf(stderr, "kernel_launch: hipMemsetAsync of the control words failed; nothing launched\n"); return; }
    Args a{};
    for (int i = 0; i < 15; ++i) a.in[i] = (const float*)d_in[i];
    a.out = (float*)d_out; a.ws = (unsigned char*)d_ws;
    for (int li = 0; li < N_LAUNCHES; ++li) {
        a.ph_lo = (N_LAUNCHES == PER_PHASE) ? li : 0; a.ph_hi = (N_LAUNCHES == PER_PHASE) ? li + 1 : PER_PHASE; a.li = li;
        hipLaunchKernelGGL(fwd_megakernel, dim3(grid), dim3(NWAVES * 64), LDS_BYTES, stream, a);
        const hipError_t le = hipPeekAtLastError();
        if (le != hipSuccess) { fprintf(stderr, "kernel_launch: launch %d failed: %s (grid %d x %d threads, %d B LDS)\n", li, hipGetErrorName(le), grid, NWAVES * 64, LDS_BYTES); break; }
    }
}
```
